# Optimizing an MI355X kernel written in HIP

```python
import math
import jax, jax.numpy as jnp
from jax import lax
import numpy as np

D_MODEL = 1024
BATCH = 8
SEQ = 4096
DEPTH = 1

N_HEADS = 8
HEAD_DIM = 128
ATTN_WIDTH = N_HEADS * HEAD_DIM
CONV_WIDTH = 1024
CONV_K = 3
MOBA_BLOCK = 256
MOBA_TOPK = 3
Q_CHUNK = 8
N_BUCKETS = 32
MAX_DISTANCE = 128
EPS = 1e-6
IN_WIDTHS = (ATTN_WIDTH, ATTN_WIDTH, ATTN_WIDTH, ATTN_WIDTH,
             CONV_WIDTH, CONV_WIDTH, CONV_WIDTH, CONV_WIDTH,
             D_MODEL, D_MODEL)
IN_COLS = sum(IN_WIDTHS)
IN_OFFSETS = tuple(int(o) for o in np.cumsum(IN_WIDTHS)[:-1])

kernel_name = "moba_shortconv_gated_hybrid_layer"


def rmsnorm(x, g):
    x32 = x.astype(jnp.float32)
    y = x32 * lax.rsqrt(jnp.mean(x32 * x32, axis=-1, keepdims=True) + EPS)
    return (y * g.astype(jnp.float32)).astype(x.dtype)


def t5_bucket(dist):
    n = jnp.maximum(dist, 0)
    max_exact = N_BUCKETS // 2
    nf = jnp.maximum(n, 1).astype(jnp.float32)
    large = max_exact + (jnp.log(nf / max_exact) / math.log(MAX_DISTANCE / max_exact)
                         * (N_BUCKETS - max_exact)).astype(jnp.int32)
    large = jnp.minimum(large, N_BUCKETS - 1)
    return jnp.where(n < max_exact, n, large)


def moba_attention(q, k, v, rel_bias):
    bsz, n_h, seq, hd = q.shape
    s_pad = -(-seq // MOBA_BLOCK) * MOBA_BLOCK
    padw = ((0, 0), (0, 0), (0, s_pad - seq), (0, 0))
    q32 = jnp.pad(q.astype(jnp.float32), padw) * (hd ** -0.5)
    nb = s_pad // MOBA_BLOCK
    kb = jnp.pad(k.astype(jnp.float32), padw).reshape(bsz, n_h, nb, MOBA_BLOCK, hd)
    vb = jnp.pad(v.astype(jnp.float32), padw).reshape(bsz, n_h, nb, MOBA_BLOCK, hd)
    bias_hb = rel_bias.astype(jnp.float32).T
    n_sel = min(MOBA_TOPK, nb - 1)
    n_chunks = s_pad // Q_CHUNK
    q_ch = q32.reshape(bsz, n_h, n_chunks, Q_CHUNK, hd).transpose(2, 0, 1, 3, 4)
    starts = jnp.arange(n_chunks, dtype=jnp.int32) * Q_CHUNK

    if n_sel > 0:
        k_mean = kb.mean(axis=3)
        scores = jnp.einsum('bhsd,bhnd->bhsn', q32, k_mean)
        q_blk = jnp.arange(s_pad) // MOBA_BLOCK
        fully_past = jnp.arange(nb)[None, :] < q_blk[:, None]
        scores = jnp.where(fully_past, scores, -jnp.inf)
        _, sel = lax.top_k(scores, n_sel)
        sel = sel.astype(jnp.int32)
    else:
        sel = jnp.zeros((bsz, n_h, s_pad, 0), jnp.int32)
    sel_ch = sel.reshape(bsz, n_h, n_chunks, Q_CHUNK, n_sel).transpose(2, 0, 1, 3, 4)

    b_idx = jnp.arange(bsz)[:, None, None, None]
    h_idx = jnp.arange(n_h)[None, :, None, None]
    offs = jnp.arange(MOBA_BLOCK, dtype=jnp.int32)

    def chunk(args):
        qc, selc, c0 = args
        qpos = c0 + jnp.arange(Q_CHUNK, dtype=jnp.int32)
        own = c0 // MOBA_BLOCK
        k_own = kb[:, :, own]
        v_own = vb[:, :, own]
        dist_own = qpos[:, None] - (own * MOBA_BLOCK + offs)[None, :]
        lg_own = jnp.einsum('bhqd,bhkd->bhqk', qc, k_own) + bias_hb[:, t5_bucket(dist_own)]
        lg_own = jnp.where(dist_own >= 0, lg_own, -jnp.inf)
        k_sel = kb[b_idx, h_idx, selc]
        v_sel = vb[b_idx, h_idx, selc]
        dist_sel = qpos[:, None, None] - (selc[..., None] * MOBA_BLOCK + offs)
        lg_sel = (jnp.einsum('bhqd,bhqnkd->bhqnk', qc, k_sel)
                  + bias_hb[h_idx[..., None], t5_bucket(dist_sel)])
        lg_sel = jnp.where((selc < own)[..., None], lg_sel, -jnp.inf)
        logits = jnp.concatenate(
            [lg_sel.reshape(bsz, n_h, Q_CHUNK, n_sel * MOBA_BLOCK), lg_own], axis=-1)
        p = jax.nn.softmax(logits, axis=-1)
        p_sel = p[..., :n_sel * MOBA_BLOCK].reshape(bsz, n_h, Q_CHUNK, n_sel, MOBA_BLOCK)
        p_own = p[..., n_sel * MOBA_BLOCK:]
        return (jnp.einsum('bhqnk,bhqnkd->bhqd', p_sel, v_sel)
                + jnp.einsum('bhqk,bhkd->bhqd', p_own, v_own))

    out = lax.map(chunk, (q_ch, sel_ch, starts))
    out = out.transpose(1, 2, 0, 3, 4).reshape(bsz, n_h, s_pad, hd)[:, :, :seq]
    return out.astype(q.dtype)


def short_conv(cb, cc, cx, conv_w):
    u = cc * cx
    y = lax.conv_general_dilated(
        u, conv_w[:, None, :].astype(u.dtype), window_strides=(1,),
        padding=[(CONV_K - 1, 0)], dimension_numbers=('NWC', 'WIO', 'NWC'),
        feature_group_count=CONV_WIDTH)
    return cb * y


def split_heads(t):
    b, s, _ = t.shape
    return t.reshape(b, s, N_HEADS, HEAD_DIM).transpose(0, 2, 1, 3)


def hybrid_layer(x, c, norm_g, w_ada, b_ada, w_in, conv_w, w_o_attn, w_o_conv, w_out, rel_bias):
    bsz, seq, _ = x.shape
    mod = jax.nn.silu(c) @ w_ada + b_ada
    shift, scale, gate = jnp.split(mod, 3, axis=-1)
    h = rmsnorm(x, norm_g) * (1 + scale[:, None, :]) + shift[:, None, :]
    proj = h @ w_in
    q, k, v, g_attn, cb, cc, cx, g_conv, m_attn, m_conv = jnp.split(proj, IN_OFFSETS, axis=-1)
    attn = moba_attention(split_heads(q), split_heads(k), split_heads(v), rel_bias)
    attn = attn.transpose(0, 2, 1, 3).reshape(bsz, seq, ATTN_WIDTH)
    y_attn = (attn * jax.nn.silu(g_attn)) @ w_o_attn
    y_conv = (short_conv(cb, cc, cx, conv_w) * jax.nn.silu(g_conv)) @ w_o_conv
    merged = jax.nn.sigmoid(m_attn) * y_attn + jax.nn.sigmoid(m_conv) * y_conv
    return x + gate[:, None, :] * (merged @ w_out)


def setup_inputs(seed: int = 0) -> dict:
    key = jax.random.key(seed)
    ks = jax.random.split(key, 13)
    nrm = jax.random.normal
    f32 = jnp.float32
    return {
        "x": nrm(ks[0], (BATCH, SEQ, D_MODEL), f32),
        "c": nrm(ks[1], (BATCH, D_MODEL), f32),
        "norm_g": 1.0 + 0.05 * nrm(ks[2], (DEPTH, D_MODEL), f32),
        "w_ada": 0.5 * D_MODEL ** -0.5 * nrm(ks[3], (DEPTH, D_MODEL, 3 * D_MODEL), f32),
        "b_ada": 0.1 * nrm(ks[4], (DEPTH, 3 * D_MODEL), f32),
        "w_in": D_MODEL ** -0.5 * nrm(ks[5], (DEPTH, D_MODEL, IN_COLS), f32),
        "conv_w": CONV_K ** -0.5 * nrm(ks[6], (DEPTH, CONV_K, CONV_WIDTH), f32),
        "w_o_attn": ATTN_WIDTH ** -0.5 * nrm(ks[7], (DEPTH, ATTN_WIDTH, D_MODEL), f32),
        "w_o_conv": CONV_WIDTH ** -0.5 * nrm(ks[8], (DEPTH, CONV_WIDTH, D_MODEL), f32),
        "w_out": D_MODEL ** -0.5 * nrm(ks[9], (DEPTH, D_MODEL, D_MODEL), f32),
        "rel_bias": 0.5 * nrm(ks[10], (N_BUCKETS, N_HEADS), f32),
        "final_g": 1.0 + 0.05 * nrm(ks[11], (D_MODEL,), f32),
    }


def reference(x, c, norm_g, w_ada, b_ada, w_in, conv_w, w_o_attn, w_o_conv, w_out, rel_bias, final_g):
    for layer in range(DEPTH):
        x = hybrid_layer(x, c, norm_g[layer], w_ada[layer], b_ada[layer], w_in[layer],
                         conv_w[layer], w_o_attn[layer], w_o_conv[layer], w_out[layer], rel_bias)
    return rmsnorm(x, final_g)
```

```cpp
#include <hip/hip_runtime.h>
#include <cstdio>
#include <cstdint>

constexpr int BATCH = 8, SEQ = 4096, DM = 1024, NH = 8, HD = 128, NBLK = 16, MBLK = 256;
constexpr int MTOK = BATCH * SEQ;
constexpr int NIN = 10240;
constexpr float EPS = 1e-6f;
constexpr float LOG2E = 1.4426950408889634f;
constexpr float QSCALE = 0.08838834764831845f * 1.4426950408889634f;

namespace pg8 {
#define PG8_LAS __attribute__((address_space(3)))
typedef unsigned short bf16_t;
typedef short bf16x8 __attribute__((ext_vector_type(8)));
typedef float f32x4 __attribute__((ext_vector_type(4)));
typedef unsigned u32x4 __attribute__((ext_vector_type(4)));
constexpr int BM = 256, BK = 64, HALF = 128, HTB = HALF * BK * 2  , STAGE_BYTES = 8 * HTB, NXCD = 8, WGM = 8;

__host__ __device__ __forceinline__ int lds_byte(int r, int c) { const int st = (r >> 4) * 2 + (c >> 5), rr = r & 15, cc = c & 31, ob = rr * 64 + cc * 2; return st * 1024 + (ob ^ (((ob >> 9) & 1) << 5)); }
__host__ __device__ __forceinline__ void stage_rc(int b, int& R, int& C) { const int st = b / 1024, sb = b % 1024, swz = sb ^ (((sb >> 9) & 1) << 5); R = (st >> 1) * 16 + swz / 64; C = (st & 1) * 32 + (swz % 64) / 2; }
__host__ __device__ __forceinline__ int perm32(int rho) { const int n = rho >> 4, i = rho & 15; return 8 * (i >> 2) + 4 * n + (i & 3); }

struct Unit { int pm, pn, sel; };
struct Gemm { const bf16_t* A; const bf16_t* Bt; const bf16_t* A1; const bf16_t* Bt1; int M, N, K; };

struct StaticOrder {
    int nM, nN, nwg, G, c;
    __host__ __device__ void init(int M, int N, int G_, int c_) { nM = M / BM; nN = N / BM; nwg = nM * nN; G = G_; c = c_; }
    __host__ __device__ bool next(int i, Unit& u) const {
        const long L = (long)i * G + c; if (L >= nwg) return false;
        int wgid = (int)L; { const int q = nwg / NXCD, r = nwg % NXCD, xcd = wgid % NXCD, off = wgid / NXCD; wgid = (xcd < r ? xcd * (q + 1) : r * (q + 1) + (xcd - r) * q) + off; }
        const int nig = WGM * nN, gid = wgid / nig, fm = gid * WGM, gsz = (nM - fm) < WGM ? (nM - fm) : WGM;
        u.pm = fm + ((wgid % nig) % gsz); u.pn = (wgid % nig) / gsz; u.sel = 0; return true;
    }
    __device__ __forceinline__ void a_ready(const Unit&) const {}
    __device__ __forceinline__ void done(const Unit&) const {}
};
struct PairOrder {
    StaticOrder so;
    __host__ __device__ void init(int M, int N, int G_, int c_) { so.init(M, N, G_, c_); }
    __host__ __device__ bool next(int i, Unit& u) const { if (!so.next(i >> 1, u)) return false; u.sel = i & 1; return true; }
    __device__ __forceinline__ void a_ready(const Unit&) const {}
    __device__ __forceinline__ void done(const Unit&) const {}
};

__device__ __forceinline__ unsigned cvt_pk_bf16(float lo, float hi) { unsigned r; asm volatile("v_cvt_pk_bf16_f32 %0, %1, %2" : "=v"(r) : "v"(lo), "v"(hi)); return r; }
__device__ __forceinline__ float bf_lo(unsigned w) { return __uint_as_float(w << 16); }
__device__ __forceinline__ float bf_hi(unsigned w) { return __uint_as_float(w & 0xffff0000u); }
__device__ __forceinline__ float sigmoid_f(float x) { return __builtin_amdgcn_rcpf(1.0f + __builtin_amdgcn_exp2f(-LOG2E * x)); }
__device__ __forceinline__ float silu_f(float x) { return x * sigmoid_f(x); }
__device__ __forceinline__ u32x4 pack8f(const f32x4& a, const f32x4& b) { u32x4 w; w.x = cvt_pk_bf16(a[0], a[1]); w.y = cvt_pk_bf16(a[2], a[3]); w.z = cvt_pk_bf16(b[0], b[1]); w.w = cvt_pk_bf16(b[2], b[3]); return w; }


struct EpiIn {
    static constexpr bool PERM = true, AFTER_DRAIN = false;
    bf16_t* q; bf16_t* k; bf16_t* v; bf16_t* sg; bf16_t* u; bf16_t* g2; bf16_t* s1; bf16_t* s2; float* kpart;
    __device__ __forceinline__ void operator()(const f32x4 (&acc)[2][2][4][2], const Unit& un, int wr, int wc, int fr, int fq) const {
        const int pn = un.pn, pm = un.pm;
        const int row0 = pm * BM + wr * 64 + fr, col0 = wc * 32 + 8 * fq;
        if (pn < 4 || (pn >= 12 && pn < 16) || pn >= 32) {
            const int mode = pn < 4 ? 0 : (pn < 16 ? 1 : 2);
            bf16_t* base = pn < 4 ? q : (pn < 16 ? sg : (pn < 36 ? s1 : s2));
            const int colt = (pn & 3) * 256 + col0;
#pragma unroll
            for (int ai = 0; ai < 2; ++ai)
#pragma unroll
                for (int m = 0; m < 4; ++m) { bf16_t* rowp = base + (size_t)(row0 + ai * HALF + m * 16) * DM + colt;
#pragma unroll
                    for (int bj = 0; bj < 2; ++bj) { f32x4 v0 = acc[ai][bj][m][0], v1 = acc[ai][bj][m][1];
#pragma unroll
                        for (int e = 0; e < 4; ++e) {
                            if (mode == 0) { v0[e] *= QSCALE; v1[e] *= QSCALE; }
                            else if (mode == 1) { v0[e] = silu_f(v0[e]); v1[e] = silu_f(v1[e]); }
                            else { v0[e] = sigmoid_f(v0[e]); v1[e] = sigmoid_f(v1[e]); } }
                        *(u32x4*)(rowp + bj * HALF) = pack8f(v0, v1); } }
        } else if (pn < 12) {
            const bool isk = pn < 8; bf16_t* base = isk ? k : v;
            const int b = pm >> 4, blk = pm & 15, trow0 = blk * 256 + wr * 64 + fr, h0 = (pn & 3) * 2;
#pragma unroll
            for (int bj = 0; bj < 2; ++bj) { bf16_t* hb = base + ((size_t)(b * NH + h0 + bj) * SEQ) * HD + col0;
#pragma unroll
                for (int ai = 0; ai < 2; ++ai)
#pragma unroll
                    for (int m = 0; m < 4; ++m) *(u32x4*)(hb + (size_t)(trow0 + ai * HALF + m * 16) * HD) = pack8f(acc[ai][bj][m][0], acc[ai][bj][m][1]); }
            if (isk) {
#pragma unroll
                for (int bj = 0; bj < 2; ++bj) { f32x4 s0 = {0.f, 0.f, 0.f, 0.f}, s1v = {0.f, 0.f, 0.f, 0.f};
#pragma unroll
                    for (int ai = 0; ai < 2; ++ai)
#pragma unroll
                        for (int m = 0; m < 4; ++m) { s0 += acc[ai][bj][m][0]; s1v += acc[ai][bj][m][1]; }
#pragma unroll
                    for (int e = 0; e < 4; ++e) {
#pragma unroll
                        for (int o = 1; o < 16; o <<= 1) { s0[e] += __shfl_xor(s0[e], o); s1v[e] += __shfl_xor(s1v[e], o); } }
                    if (fr == 0) { float* kp = kpart + ((size_t)((b * NH + h0 + bj) * NBLK + blk) * 2 + wr) * HD + col0; *(f32x4*)kp = s0; *(f32x4*)(kp + 4) = s1v; } }
            }
        } else {
            const bool isu = pn < 24; bf16_t* base = isu ? u : g2; const int colt = ((pn - 16) & 7) * 128 + col0;
#pragma unroll
            for (int ai = 0; ai < 2; ++ai)
#pragma unroll
                for (int m = 0; m < 4; ++m) { f32x4 a0 = acc[ai][0][m][0], a1 = acc[ai][0][m][1], b0 = acc[ai][1][m][0], b1 = acc[ai][1][m][1];
                    if (!isu) {
#pragma unroll
                        for (int e = 0; e < 4; ++e) { b0[e] = silu_f(b0[e]); b1[e] = silu_f(b1[e]); } }
                    *(u32x4*)(base + (size_t)(row0 + ai * HALF + m * 16) * DM + colt) = pack8f(a0 * b0, a1 * b1); }
        }
    }
};
struct EpiMerge {
    static constexpr bool PERM = true, AFTER_DRAIN = false;
    const bf16_t* s1; const bf16_t* s2; float* P; bf16_t* merged;
    __device__ __forceinline__ void operator()(const f32x4 (&acc)[2][2][4][2], const Unit& un, int wr, int wc, int fr, int fq) const {
        const int row0 = un.pm * BM + wr * 64 + fr, colt = un.pn * BM + wc * 32 + 8 * fq;
        const bf16_t* sb = un.sel ? s2 : s1;
        f32x4* pt = (f32x4*)P + ((size_t)(un.pm * 4 + un.pn) * 32) * 512 + threadIdx.x;
#pragma unroll
        for (int ai = 0; ai < 2; ++ai)
#pragma unroll
            for (int m = 0; m < 4; ++m) { const size_t ro = (size_t)(row0 + ai * HALF + m * 16) * DM + colt;
#pragma unroll
                for (int bj = 0; bj < 2; ++bj) { const u32x4 sw = *(const u32x4*)(sb + ro + bj * HALF);
                    f32x4 g0 = {bf_lo(sw.x), bf_hi(sw.x), bf_lo(sw.y), bf_hi(sw.y)}, g1 = {bf_lo(sw.z), bf_hi(sw.z), bf_lo(sw.w), bf_hi(sw.w)};
                    f32x4 v0 = acc[ai][bj][m][0] * g0, v1 = acc[ai][bj][m][1] * g1;
                    const int idx = ((ai * 2 + bj) * 4 + m) * 2;
                    if (un.sel == 0) { pt[(size_t)idx * 512] = v0; pt[(size_t)(idx + 1) * 512] = v1; }
                    else { v0 += pt[(size_t)idx * 512]; v1 += pt[(size_t)(idx + 1) * 512]; *(u32x4*)(merged + ro + bj * HALF) = pack8f(v0, v1); } } }
    }
};
struct EpiRes {
    static constexpr bool PERM = false, AFTER_DRAIN = false;
    const float* x; const float* gate; float* y;
    __device__ __forceinline__ void operator()(const f32x4 (&acc)[2][2][4][2], const Unit& un, int wr, int wc, int fr, int fq) const {
        const int row0 = un.pm * BM + wr * 64 + fr, col0 = un.pn * BM + wc * 32 + 4 * fq; const int b = un.pm >> 4;
        f32x4 gv[2][2];
#pragma unroll
        for (int bj = 0; bj < 2; ++bj)
#pragma unroll
            for (int n = 0; n < 2; ++n) gv[bj][n] = *(const f32x4*)(gate + (size_t)b * 3072 + col0 + bj * HALF + n * 16);
#pragma unroll
        for (int ai = 0; ai < 2; ++ai)
#pragma unroll
            for (int m = 0; m < 4; ++m) { const size_t ro = (size_t)(row0 + ai * HALF + m * 16) * DM + col0;
#pragma unroll
                for (int bj = 0; bj < 2; ++bj)
#pragma unroll
                    for (int n = 0; n < 2; ++n) { const f32x4 xv = *(const f32x4*)(x + ro + bj * HALF + n * 16); *(f32x4*)(y + ro + bj * HALF + n * 16) = xv + gv[bj][n] * acc[ai][bj][m][n]; } }
    }
};

template <class Epi, class Sched, bool ALIGN_EPI = false, bool SP2 = false>
__device__ __forceinline__ void gemm_phase(PG8_LAS unsigned char* lds, const Gemm g, const Sched& S, const Epi& E) {
    const int tid = threadIdx.x, wid = __builtin_amdgcn_readfirstlane(tid >> 6), lane = tid & 63, wr = wid >> 2, wc = wid & 3, fr = lane & 15, fq = lane >> 4;
    const int K = g.K, nt = K / BK;
    unsigned voffA[2], voffB[2];
#pragma unroll
    for (int i = 0; i < 2; ++i) { int R, C; stage_rc(tid * 16 + i * 8192, R, C); const int Rb = Epi::PERM ? ((R & ~31) + perm32(R & 31)) : R;
        voffA[i] = (unsigned)(R * K + C) * 2u; voffB[i] = (unsigned)(Rb * K + C) * 2u; }
    const size_t kstep = (size_t)(BK * 2);
    const size_t hstep = (size_t)HALF * K * 2;
    const size_t tstep = 2 * hstep;
    const unsigned ldsw = (unsigned)wid * 1024u;
    const int aoff = lds_byte(wr * 64 + fr, fq * 8), boff = lds_byte(wc * 32 + fr, fq * 8);
#define PG8_SA(b, h) (((b) * 2 + (h)) * HTB)
#define PG8_SB(b, h) ((4 + (b) * 2 + (h)) * HTB)
#define PG8_STAGE(bufoff, gbase, voff) do { _Pragma("unroll") for (int _i = 0; _i < 2; ++_i) \
        __builtin_amdgcn_global_load_lds((const unsigned*)((const char*)(gbase) + (voff)[_i]), (PG8_LAS unsigned*)(lds + (bufoff) + ldsw + _i * 8192), 16, 0, 0); } while (0)
#define PG8_LDA(dst, b, h) do { _Pragma("unroll") for (int m = 0; m < 4; ++m) _Pragma("unroll") for (int k = 0; k < 2; ++k) dst[m][k] = *(const PG8_LAS bf16x8*)(lds + PG8_SA(b, h) + aoff + m * 2048 + k * 1024); } while (0)
#define PG8_LDB(dst, b, h) do { _Pragma("unroll") for (int n = 0; n < 2; ++n) _Pragma("unroll") for (int k = 0; k < 2; ++k) dst[n][k] = *(const PG8_LAS bf16x8*)(lds + PG8_SB(b, h) + boff + n * 2048 + k * 1024); } while (0)
#define PG8_MMA(ai, bj, At, Bt) do { __builtin_amdgcn_s_setprio(1); _Pragma("unroll") for (int m = 0; m < 4; ++m) _Pragma("unroll") for (int n = 0; n < 2; ++n) _Pragma("unroll") for (int k = 0; k < 2; ++k) \
        acc[ai][bj][m][n] = __builtin_amdgcn_mfma_f32_16x16x32_bf16(Bt[n][k], At[m][k], acc[ai][bj][m][n], 0, 0, 0); __builtin_amdgcn_s_setprio(0); } while (0)
#define PG8_WAIT_V(n) asm volatile("s_waitcnt vmcnt(" #n ")" ::: "memory")
#define PG8_WAIT_L(n) asm volatile("s_waitcnt lgkmcnt(" #n ")" ::: "memory")
#define PG8_BAR __builtin_amdgcn_s_barrier()
#define PG8_SCHED __builtin_amdgcn_sched_barrier(0)
    Unit cur, nxt; int ui = 0;
    if (!S.next(0, cur)) return;
    f32x4 acc[2][2][4][2];
#pragma unroll
    for (int a = 0; a < 2; ++a)
#pragma unroll
        for (int b = 0; b < 2; ++b)
#pragma unroll
            for (int m = 0; m < 4; ++m)
#pragma unroll
                for (int n = 0; n < 2; ++n) acc[a][b][m][n] = (f32x4){0.f, 0.f, 0.f, 0.f};
    bf16x8 At[4][2], B0[2][2], B1[2][2];
    const char* cA = (const char*)(cur.sel ? g.A1 : g.A) + (size_t)cur.pm * tstep; const char* cB = (const char*)(cur.sel ? g.Bt1 : g.Bt) + (size_t)cur.pn * tstep;
    S.a_ready(cur);
    if constexpr (SP2) {
        PG8_STAGE(PG8_SB(0, 0), cB, voffB); PG8_STAGE(PG8_SB(0, 1), cB + hstep, voffB); PG8_STAGE(PG8_SA(0, 0), cA, voffA); PG8_STAGE(PG8_SA(0, 1), cA + hstep, voffA);
        if (wr == 1) PG8_BAR;
        PG8_WAIT_V(2); PG8_BAR;
        PG8_STAGE(PG8_SB(1, 0), cB + kstep, voffB); PG8_STAGE(PG8_SA(1, 0), cA + kstep, voffA); PG8_STAGE(PG8_SB(1, 1), cB + hstep + kstep, voffB);
        PG8_WAIT_V(6); PG8_BAR;
    } else {
        PG8_STAGE(PG8_SB(0, 0), cB, voffB); PG8_STAGE(PG8_SA(0, 0), cA, voffA); PG8_STAGE(PG8_SB(0, 1), cB + hstep, voffB); PG8_STAGE(PG8_SA(0, 1), cA + hstep, voffA);
        if (wr == 1) PG8_BAR;
        PG8_WAIT_V(4); PG8_BAR;
        PG8_STAGE(PG8_SB(1, 0), cB + kstep, voffB); PG8_STAGE(PG8_SA(1, 0), cA + kstep, voffA); PG8_STAGE(PG8_SB(1, 1), cB + hstep + kstep, voffB);
        PG8_WAIT_V(6); PG8_BAR;
    }
    for (;;) {
        const bool has_next = S.next(ui + 1, nxt);
        const char* nA = has_next ? (const char*)(nxt.sel ? g.A1 : g.A) + (size_t)nxt.pm * tstep : cA; const char* nB = has_next ? (const char*)(nxt.sel ? g.Bt1 : g.Bt) + (size_t)nxt.pn * tstep : cB;
        for (int t = 0; t < nt; t += 2) {
            const bool last = (t == nt - 2);
            const char* a1 = cA + (size_t)(t + 1) * kstep;
            const char* a2 = last ? nA : cA + (size_t)(t + 2) * kstep; const char* b2 = last ? nB : cB + (size_t)(t + 2) * kstep;
            const char* a3 = a2 + kstep; const char* b3 = b2 + kstep;
            if (last && has_next) S.a_ready(nxt);
            if constexpr (SP2) {
            PG8_LDB(B0, 0, 0); PG8_LDB(B1, 0, 1); PG8_SCHED; PG8_LDA(At, 0, 0); PG8_STAGE(PG8_SA(1, 1), a1 + hstep, voffA);
            PG8_WAIT_V(8); PG8_WAIT_L(0); PG8_BAR; PG8_MMA(0, 0, At, B0); PG8_MMA(0, 1, At, B1); PG8_BAR; PG8_SCHED;
            PG8_LDA(At, 0, 1); PG8_STAGE(PG8_SB(0, 0), b2, voffB); PG8_STAGE(PG8_SB(0, 1), b2 + hstep, voffB); PG8_STAGE(PG8_SA(0, 0), a2, voffA);
            PG8_WAIT_V(8); PG8_WAIT_L(0); PG8_BAR; PG8_MMA(1, 0, At, B0); PG8_MMA(1, 1, At, B1); PG8_BAR; PG8_SCHED;
            PG8_LDB(B0, 1, 0); PG8_LDB(B1, 1, 1); PG8_SCHED; PG8_LDA(At, 1, 0); PG8_STAGE(PG8_SA(0, 1), a2 + hstep, voffA);
            PG8_WAIT_V(8); PG8_WAIT_L(0); PG8_BAR; PG8_MMA(0, 0, At, B0); PG8_MMA(0, 1, At, B1); PG8_BAR; PG8_SCHED;
            PG8_LDA(At, 1, 1); PG8_STAGE(PG8_SB(1, 0), b3, voffB); PG8_STAGE(PG8_SB(1, 1), b3 + hstep, voffB); PG8_STAGE(PG8_SA(1, 0), a3, voffA);
            PG8_WAIT_V(8); PG8_WAIT_L(0); PG8_BAR; PG8_MMA(1, 0, At, B0); PG8_MMA(1, 1, At, B1); PG8_BAR; PG8_SCHED;
            } else {
            PG8_LDB(B0, 0, 0); PG8_SCHED; PG8_LDA(At, 0, 0); PG8_STAGE(PG8_SA(1, 1), a1 + hstep, voffA);
            PG8_WAIT_L(8); PG8_BAR; PG8_WAIT_L(0); PG8_MMA(0, 0, At, B0); PG8_BAR; PG8_SCHED;
            PG8_LDB(B1, 0, 1); PG8_STAGE(PG8_SB(0, 0), b2, voffB);
            PG8_BAR; PG8_WAIT_L(0); PG8_MMA(0, 1, At, B1); PG8_BAR;
            PG8_LDA(At, 0, 1); PG8_STAGE(PG8_SA(0, 0), a2, voffA);
            PG8_BAR; PG8_WAIT_L(0); PG8_MMA(1, 0, At, B0); PG8_BAR; PG8_SCHED;
            PG8_STAGE(PG8_SB(0, 1), b2 + hstep, voffB);
            PG8_WAIT_V(6); PG8_BAR; PG8_MMA(1, 1, At, B1); PG8_BAR;
            PG8_LDB(B0, 1, 0); PG8_SCHED; PG8_LDA(At, 1, 0); PG8_STAGE(PG8_SA(0, 1), a2 + hstep, voffA);
            PG8_WAIT_L(8); PG8_BAR; PG8_WAIT_L(0); PG8_MMA(0, 0, At, B0); PG8_BAR; PG8_SCHED;
            PG8_LDB(B1, 1, 1); PG8_STAGE(PG8_SB(1, 0), b3, voffB);
            PG8_BAR; PG8_WAIT_L(0); PG8_MMA(0, 1, At, B1); PG8_BAR;
            PG8_LDA(At, 1, 1); PG8_STAGE(PG8_SA(1, 0), a3, voffA);
            PG8_BAR; PG8_WAIT_L(0); PG8_MMA(1, 0, At, B0); PG8_BAR; PG8_SCHED;
            PG8_STAGE(PG8_SB(1, 1), b3 + hstep, voffB);
            PG8_WAIT_V(6); PG8_BAR; PG8_MMA(1, 1, At, B1); PG8_BAR;
            }
        }
        if constexpr (ALIGN_EPI) { if (wr == 0) PG8_BAR; }
        if constexpr (!Epi::AFTER_DRAIN) { E(acc, cur, wr, wc, fr, fq); S.done(cur); }
        if (!has_next) break;
#pragma unroll
        for (int a = 0; a < 2; ++a)
#pragma unroll
            for (int b = 0; b < 2; ++b)
#pragma unroll
                for (int m = 0; m < 4; ++m)
#pragma unroll
                    for (int n = 0; n < 2; ++n) acc[a][b][m][n] = (f32x4){0.f, 0.f, 0.f, 0.f};
        cur = nxt; cA = nA; cB = nB; ++ui;
        if constexpr (ALIGN_EPI) { if (wr == 1) PG8_BAR; }
    }
    PG8_WAIT_V(0);
    if constexpr (!ALIGN_EPI) { if (wr == 0) PG8_BAR; }
    PG8_BAR;
    if constexpr (Epi::AFTER_DRAIN) { E.fused(acc, cur, wr, wc, fr, fq, lds, wid, lane); S.done(cur); }
#undef PG8_SA
#undef PG8_SB
#undef PG8_STAGE
#undef PG8_LDA
#undef PG8_LDB
#undef PG8_MMA
#undef PG8_WAIT_V
#undef PG8_WAIT_L
#undef PG8_BAR
#undef PG8_SCHED
}
}

namespace att {
typedef unsigned short bf16;
typedef short bf16x8 __attribute__((ext_vector_type(8)));
typedef short s16x4 __attribute__((ext_vector_type(4)));
typedef float f32x16 __attribute__((ext_vector_type(16)));
typedef float f32x4 __attribute__((ext_vector_type(4)));
typedef unsigned u32x4 __attribute__((ext_vector_type(4)));
typedef unsigned u32x2 __attribute__((ext_vector_type(2)));
constexpr int D = 128, NW = 8, QBLK = 32, KVBLK = 64, QB = NW * QBLK, PITCH = 1024;
constexpr int SHM_V = KVBLK * D * 2, SHM_K = KVBLK * D * 2;
constexpr int L_V = 0, L_K = 2 * SHM_V, L_WS = L_K + 2 * SHM_K, L_KM = L_WS + NW * 64 * 4, L_TAB = L_KM + 16 * 128 * 2, L_OST = L_TAB + 2048, L_BYTES = L_OST + NW * 32 * 128 * 2;
constexpr float THR2 = 11.5f;

#define KSWZ(row, colB) ((row) * 256 + ((colB) ^ (((row) & 7) << 4)))
#define SBAR() __builtin_amdgcn_sched_barrier(0)
__device__ __forceinline__ int v_st(int k, int c) { const int kk = (k & ~0xC) | ((k & 4) << 1) | ((k & 8) >> 1); return ((kk >> 3) * 4 + (c >> 5)) * 512 + ((kk & 7) * 32 + (c & 31)) * 2; }
__device__ __forceinline__ int v_rd_base(int lane) { return ((lane & 3) << 3) | (((lane >> 2) & 3) << 6) | (((lane >> 4) & 1) << 5) | (((lane >> 5) & 1) << 8); }
constexpr int v_rd_off(int d0, int ks, int half) { return d0 * 512 + ks * 4096 + half * 2048; }
__device__ __forceinline__ int crow(int r, int hi) { return (r & 3) + 8 * (r >> 2) + 4 * hi; }
__device__ __forceinline__ unsigned cvtpk(float lo, float hi) {
    unsigned r; asm volatile("v_cvt_pk_bf16_f32 %0, %1, %2" : "=v"(r) : "v"(lo), "v"(hi)); return r;
}
__device__ __forceinline__ bf16x8 load8(const bf16* p) { return *reinterpret_cast<const bf16x8*>(p); }

__device__ __forceinline__ void bias_tile(f32x16& p0, f32x16& p1, int dq, const float* tab) {
#pragma unroll
    for (int r = 0; r < 16; ++r) {
        const int c = (r & 3) + 8 * (r >> 2);
        int d0 = dq - c, d1 = dq - c - 32;
        d0 = d0 < -1 ? -1 : (d0 > 128 ? 128 : d0); d1 = d1 < -1 ? -1 : (d1 > 128 ? 128 : d1);
        p0[r] += tab[d0 + 1]; p1[r] += tab[d1 + 1];
    }
}
__device__ __forceinline__ void partialSM(f32x16& p0, f32x16& p1, float& m_reg, float& alpha, float bl) {
    float pmax = p0[0];
#pragma unroll
    for (int r = 1; r < 16; ++r) pmax = fmaxf(pmax, p0[r]);
#pragma unroll
    for (int r = 0; r < 16; ++r) pmax = fmaxf(pmax, p1[r]);
    { auto rr = __builtin_amdgcn_permlane32_swap(__float_as_uint(pmax), __float_as_uint(pmax), false, false);
      pmax = fmaxf(__uint_as_float(rr[0]), __uint_as_float(rr[1])); }
    const float zmax = pmax + bl;
    float mn;
    if (__builtin_expect(__all((zmax - m_reg) <= THR2), 1)) { mn = m_reg; alpha = 1.f; }
    else { mn = fmaxf(m_reg, zmax); alpha = __builtin_amdgcn_exp2f(m_reg - mn); m_reg = mn; }
    const float cl = bl - mn;
#pragma unroll
    for (int r = 0; r < 16; ++r) p0[r] = p0[r] + cl;
#pragma unroll
    for (int r = 0; r < 16; ++r) p1[r] = p1[r] + cl;
#pragma unroll
    for (int r = 0; r < 16; ++r) p0[r] = __builtin_amdgcn_exp2f(p0[r]);
}
__device__ __forceinline__ void finishSM(f32x16& p0, f32x16& p1, float alpha, float& l_reg, bf16x8& pa0, bf16x8& pa1, bf16x8& pa2, bf16x8& pa3) {
#pragma unroll
    for (int r = 0; r < 16; ++r) p1[r] = __builtin_amdgcn_exp2f(p1[r]);
    float ps = 0;
#pragma unroll
    for (int r = 0; r < 16; ++r) ps += p0[r];
#pragma unroll
    for (int r = 0; r < 16; ++r) ps += p1[r];
    { auto rr = __builtin_amdgcn_permlane32_swap(__float_as_uint(ps), __float_as_uint(ps), false, false);
      ps = __uint_as_float(rr[0]) + __uint_as_float(rr[1]); }
    l_reg = l_reg * alpha + ps;
#define PK4(P, B_, OUT) do { unsigned a0 = cvtpk(P[B_+0], P[B_+1]), a1 = cvtpk(P[B_+2], P[B_+3]);                          \
        unsigned b0 = cvtpk(P[B_+4], P[B_+5]), b1 = cvtpk(P[B_+6], P[B_+7]);                                             \
        auto r0 = __builtin_amdgcn_permlane32_swap(a0, b0, false, false); auto r1 = __builtin_amdgcn_permlane32_swap(a1, b1, false, false); \
        u32x4 w = {r0[0], r1[0], r0[1], r1[1]}; OUT = *reinterpret_cast<bf16x8*>(&w); } while (0)
    PK4(p0, 0, pa0); PK4(p0, 8, pa1); PK4(p1, 0, pa2); PK4(p1, 8, pa3);
#undef PK4
}
template <int KB>
__device__ __forceinline__ void qkt(f32x16& p0, f32x16& p1, const char* K_lds, int r32, int hi, const bf16x8* qr) {
    p0 = f32x16{}; p1 = f32x16{};
    const char* kb[4];
#pragma unroll
    for (int dd = 0; dd < 4; ++dd) kb[dd] = K_lds + KB * SHM_K + KSWZ(r32, (dd * 16 + hi * 8) * 2);
#pragma unroll
    for (int d0 = 0; d0 < 8; ++d0) { const char* a = kb[d0 & 3] + (d0 >> 2) * 128;
        bf16x8 b0 = *reinterpret_cast<const bf16x8*>(a);
        bf16x8 b1 = *reinterpret_cast<const bf16x8*>(a + 32 * 256);
        p0 = __builtin_amdgcn_mfma_f32_32x32x16_bf16(b0, qr[d0], p0, 0, 0, 0);
        p1 = __builtin_amdgcn_mfma_f32_32x32x16_bf16(b1, qr[d0], p1, 0, 0, 0); }
}
template <int VB>
__device__ __forceinline__ void pv_tile(f32x16* o, int vb0, bf16x8 pa0, bf16x8 pa1, bf16x8 pa2, bf16x8 pa3) {
#define TRRD(dst, off) asm volatile("ds_read_b64_tr_b16 %0, %1 offset:%2" : "=&v"(dst) : "v"(vb0), "i"(off) : "memory")
#define PV_D0(d0) do { s16x4 l0, l1, l2, l3, h0, h1, h2, h3; constexpr int b_ = VB * SHM_V + v_rd_off(d0, 0, 0);     \
        TRRD(l0, b_); TRRD(h0, b_ + 2048); TRRD(l1, b_ + 4096); TRRD(h1, b_ + 6144); TRRD(l2, b_ + 8192); TRRD(h2, b_ + 10240); TRRD(l3, b_ + 12288); TRRD(h3, b_ + 14336); \
        asm volatile("s_waitcnt lgkmcnt(0)" ::: "memory"); SBAR();                 \
        o[d0] = __builtin_amdgcn_mfma_f32_32x32x16_bf16(pa0, (bf16x8){l0[0], l0[1], l0[2], l0[3], h0[0], h0[1], h0[2], h0[3]}, o[d0], 0, 0, 0);   \
        o[d0] = __builtin_amdgcn_mfma_f32_32x32x16_bf16(pa1, (bf16x8){l1[0], l1[1], l1[2], l1[3], h1[0], h1[1], h1[2], h1[3]}, o[d0], 0, 0, 0);   \
        o[d0] = __builtin_amdgcn_mfma_f32_32x32x16_bf16(pa2, (bf16x8){l2[0], l2[1], l2[2], l2[3], h2[0], h2[1], h2[2], h2[3]}, o[d0], 0, 0, 0);   \
        o[d0] = __builtin_amdgcn_mfma_f32_32x32x16_bf16(pa3, (bf16x8){l3[0], l3[1], l3[2], l3[3], h3[0], h3[1], h3[2], h3[3]}, o[d0], 0, 0, 0); } while (0)
    PV_D0(0); PV_D0(1); PV_D0(2); PV_D0(3);
#undef PV_D0
#undef TRRD
}

struct URef { const bf16* Q; const bf16* K; const bf16* V; bf16* O; const bf16* SG; const float* KP; int own; int h; };
struct Seam { bf16x8 qr[8]; bf16x8 st_v0, st_v1, st_k0, st_k1; };
#define ROW(p, k0, rr) ((p) + (size_t)((k0) + (rr)) * D + sc)
#define VMW() asm volatile("s_waitcnt vmcnt(0)" ::: "memory")
#define VMWN(n) asm volatile("s_waitcnt vmcnt(%0)" :: "i"(n) : "memory")
#define SLOAD_H(Kp, Vp, k0) do { S.st_v0 = load8(ROW(Vp, k0, sr)); S.st_v1 = load8(ROW(Vp, k0, 32 + sr));              \
                         S.st_k0 = load8(ROW(Kp, k0, sr)); S.st_k1 = load8(ROW(Kp, k0, 32 + sr)); } while (0)
#define SWRITE_HK(bf) do { *(bf16x8*)(K_lds + (bf) * SHM_K + kws) = S.st_k0; *(bf16x8*)(K_lds + (bf) * SHM_K + kws + 32 * 256) = S.st_k1; } while (0)
#define SWRITE_HV(bf) do { *(bf16x8*)(V_lds + (bf) * SHM_V + vst0) = S.st_v0; *(bf16x8*)(V_lds + (bf) * SHM_V + vst1) = S.st_v1; } while (0)
#define SWRITE_H(bf) do { SWRITE_HV(bf); SWRITE_HK(bf); } while (0)
__device__ __forceinline__ void prime(const URef& cur, char* lds, Seam& S) {
    const int tid = threadIdx.x, wid = __builtin_amdgcn_readfirstlane(tid >> 6), lane = tid & 63, r32 = lane & 31, hi = lane >> 5;
    const int sr = tid >> 4, sc = (tid & 15) * 8, kws = KSWZ(sr, sc * 2); char* K_lds = lds + L_K;
#pragma unroll
    for (int d0 = 0; d0 < 8; ++d0) S.qr[d0] = load8(cur.Q + (size_t)(wid * QBLK + r32) * PITCH + d0 * 16 + hi * 8);
    SLOAD_H(cur.K, cur.V, 0); VMW(); SWRITE_HK(0);
    __syncthreads();
}
__device__ __forceinline__ void block(const URef& cur, const URef& nxt, const float* __restrict__ rel_bias, char* lds, Seam& S) {
    const int tid = threadIdx.x, wid = __builtin_amdgcn_readfirstlane(tid >> 6), lane = tid & 63, r32 = lane & 31, hi = lane >> 5;
    const int own = cur.own, NT = 4 * own + 4;
    char* V_lds = lds + L_V; char* K_lds = lds + L_K;
    float* ws = (float*)(lds + L_WS) + wid * 64; float* li_l = ws, * al_l = ws + 32;
    float* tab = (float*)(lds + L_TAB);
    { int tidp = tid; asm volatile("" : "+v"(tidp));
      const int j = tidp >> 5, d4 = (tidp & 31) * 4;
      const f32x4 a = *(const f32x4*)(cur.KP + (size_t)(j * 2 + 0) * D + d4), b = *(const f32x4*)(cur.KP + (size_t)(j * 2 + 1) * D + d4);
      const f32x4 s = (a + b) * (1.0f / 256.0f);
      u32x2 w; w.x = cvtpk(s[0], s[1]); w.y = cvtpk(s[2], s[3]);
      *(u32x2*)(lds + L_KM + (j * D + d4) * 2) = w;
      if (tidp < 130) { float v;
          if (tidp == 0) v = -__builtin_inff();
          else { const int n = tidp - 1; int bk = n;
                 if (n >= 16) { bk = 16 + (int)(__builtin_log2f((float)n * (1.0f / 16.0f)) * (16.0f / 3.0f)); bk = bk > 31 ? 31 : bk; }
                 v = LOG2E * rel_bias[bk * 8 + cur.h]; }
          tab[tidp] = v; } }
    __syncthreads();
    unsigned selmask = 0u;
    { f32x16 sc16 = f32x16{};
      const int rho = r32 & 15, jrow = (rho & 3) | ((rho & 4) << 1) | ((rho & 8) >> 1);
      const char* kmp = lds + L_KM + (jrow * D + hi * 8) * 2;
#pragma unroll
      for (int d0 = 0; d0 < 8; ++d0) { const bf16x8 a = *reinterpret_cast<const bf16x8*>(kmp + d0 * 32);
          sc16 = __builtin_amdgcn_mfma_f32_32x32x16_bf16(a, S.qr[d0], sc16, 0, 0, 0); }
      float v[16];
#pragma unroll
      for (int r = 0; r < 8; ++r) { auto rr = __builtin_amdgcn_permlane32_swap(__float_as_uint(sc16[r]), __float_as_uint(sc16[r]), false, false);
          v[r] = __uint_as_float(rr[0]); v[8 + r] = __uint_as_float(rr[1]); }
      const float NEG = -__builtin_inff();
#pragma unroll
      for (int j = 0; j < 16; ++j) v[j] = j < own ? v[j] : NEG;
#pragma unroll
      for (int k = 0; k < 3; ++k) { float best = NEG; int bi = 16;
#pragma unroll
          for (int j = 0; j < 16; ++j) { const bool g = v[j] > best; best = g ? v[j] : best; bi = g ? j : bi; }
          selmask |= (bi < 16) ? (1u << bi) : 0u;
#pragma unroll
          for (int j = 0; j < 16; ++j) v[j] = (j == bi) ? NEG : v[j]; } }
    const float b31 = tab[129];
    float m_reg = -1e30f, l_reg = 0; f32x16 o[4] = {};
    const int sr = tid >> 4, sc = (tid & 15) * 8, vst0 = v_st(sr, sc), vst1 = v_st(32 + sr, sc), kws = KSWZ(sr, sc * 2);
    const int vb0 = (int)(uintptr_t)V_lds + v_rd_base(lane);
    const bf16* Kh = cur.K; const bf16* Vh = cur.V;
    const int qm = own * QB + wid * QBLK + r32 - 4 * hi;
#define RESC(a) do { if (__any((a) < 1.f)) { if (hi == 0) al_l[r32] = (a); asm volatile("s_waitcnt lgkmcnt(0)" ::: "memory");              \
                     for (int d_ = 0; d_ < 4; ++d_) for (int r = 0; r < 16; ++r) o[d_][r] *= al_l[crow(r, hi)]; } } while (0)
#define KBASE(t) ((t) * KVBLK)
#define ISVAR(t) ((t) >= 4 * own || ((t) == 4 * own - 1 && wid <= 3) || ((t) == 4 * own - 2 && wid <= 1))
#define BIASV(P0_, P1_, t) do { if (ISVAR(t)) bias_tile(P0_, P1_, qm - KBASE(t), tab); } while (0)
#define BLANE(t) (((t) >= 4 * own) ? 0.f : ((((selmask >> ((t) >> 2)) & 1u) != 0u) ? (ISVAR(t) ? 0.f : b31) : -__builtin_inff()))
#define SEAM_K0() do { VMWN(8); SWRITE_HK(0); SBAR(); } while (0)
    f32x16 pA0, pA1, pB0, pB1; float alA, alB; bf16x8 pa0, pa1, pa2, pa3;
    SWRITE_HV(0); SBAR();
    SLOAD_H(Kh, Vh, KBASE(1));
    SBAR(); qkt<0>(pA0, pA1, K_lds, r32, hi, S.qr);
    BIASV(pA0, pA1, 0); partialSM(pA0, pA1, m_reg, alA, BLANE(0));
    VMW(); SWRITE_H(1);
    __syncthreads();
#define HALF_STEP(PX0, PX1, alX, PY0, PY1, alY, t, KB, VB, SB) do {                                                      \
        SBAR(); qkt<KB>(PX0, PX1, K_lds, r32, hi, S.qr);                                             \
        finishSM(PY0, PY1, alY, l_reg, pa0, pa1, pa2, pa3); SBAR();                                                           \
        if ((t) + 1 < NT) { SLOAD_H(Kh, Vh, KBASE((t) + 1)); SBAR(); }                                               \
        pv_tile<VB>(o, vb0, pa0, pa1, pa2, pa3); BIASV(PX0, PX1, (t)); partialSM(PX0, PX1, m_reg, alX, BLANE(t));                                        \
        __syncthreads();                                                                                                      \
        if ((t) + 1 < NT) { VMW(); SWRITE_H(SB); }                                                                          \
        RESC(alX); __syncthreads(); } while (0)
    for (int t = 1; t + 1 < NT; t += 2) {
        HALF_STEP(pB0, pB1, alB, pA0, pA1, alA, t, 1, 0, 0);
        HALF_STEP(pA0, pA1, alA, pB0, pB1, alB, t + 1, 0, 1, 1);
    }
    SBAR(); qkt<1>(pB0, pB1, K_lds, r32, hi, S.qr); SBAR();
    SLOAD_H(nxt.K, nxt.V, 0); SBAR();
#pragma unroll
    for (int d0 = 0; d0 < 8; ++d0) S.qr[d0] = load8(nxt.Q + (size_t)(wid * QBLK + r32) * PITCH + d0 * 16 + hi * 8);
    SBAR();
    finishSM(pA0, pA1, alA, l_reg, pa0, pa1, pa2, pa3); SBAR();
    pv_tile<0>(o, vb0, pa0, pa1, pa2, pa3);
    BIASV(pB0, pB1, NT - 1); partialSM(pB0, pB1, m_reg, alB, BLANE(NT - 1)); __syncthreads(); RESC(alB);
    finishSM(pB0, pB1, alB, l_reg, pa0, pa1, pa2, pa3); SBAR(); pv_tile<1>(o, vb0, pa0, pa1, pa2, pa3);
    SBAR(); SEAM_K0();
    if (hi == 0) li_l[r32] = l_reg; asm volatile("s_waitcnt lgkmcnt(0)" ::: "memory");
    bf16* stg = (bf16*)(lds + L_OST) + wid * (QBLK * D);
#pragma unroll
    for (int r = 0; r < 16; ++r) { const int orow = crow(r, hi); const float rl = __builtin_amdgcn_rcpf(li_l[orow]);
#pragma unroll
        for (int d0 = 0; d0 < 4; ++d0) { const unsigned w = cvtpk(o[d0][r] * rl, 0.f); stg[orow * D + d0 * 32 + r32] = (bf16)w; } }
    asm volatile("s_waitcnt lgkmcnt(0)" ::: "memory");
#pragma unroll
    for (int i = 0; i < 8; ++i) { const int row = i * 4 + (lane >> 4), ch = lane & 15;
        const u32x4 ov = *(const u32x4*)(stg + row * D + ch * 8);
        const size_t go = (size_t)(wid * QBLK + row) * PITCH + ch * 8;
        const u32x4 gv = *(const u32x4*)(cur.SG + go);
        u32x4 w;
        w.x = cvtpk(pg8::bf_lo(ov.x) * pg8::bf_lo(gv.x), pg8::bf_hi(ov.x) * pg8::bf_hi(gv.x)); w.y = cvtpk(pg8::bf_lo(ov.y) * pg8::bf_lo(gv.y), pg8::bf_hi(ov.y) * pg8::bf_hi(gv.y));
        w.z = cvtpk(pg8::bf_lo(ov.z) * pg8::bf_lo(gv.z), pg8::bf_hi(ov.z) * pg8::bf_hi(gv.z)); w.w = cvtpk(pg8::bf_lo(ov.w) * pg8::bf_lo(gv.w), pg8::bf_hi(ov.w) * pg8::bf_hi(gv.w));
        *(u32x4*)(cur.O + go) = w; }
    __syncthreads();
#undef RESC
#undef KBASE
#undef ISVAR
#undef BIASV
#undef BLANE
#undef SEAM_K0
#undef HALF_STEP
}
#undef ROW
#undef VMW
#undef VMWN
#undef SLOAD_H
#undef SWRITE_HK
#undef SWRITE_HV
#undef SWRITE_H
#undef SBAR
#undef KSWZ
}


constexpr int NWAVES = 8;
#ifndef MK_N_LAUNCHES
#define MK_N_LAUNCHES 1
#endif
constexpr int N_LAUNCHES = MK_N_LAUNCHES;
constexpr int N_PHASES = 7;

constexpr size_t MiB = 1u << 20;
constexpr size_t WS_CTL = 0, CTL_ZERO_BYTES = 64 * 1024;
constexpr size_t WS_MOD = 1 * MiB;
constexpr size_t WS_KPART = 2 * MiB;
constexpr size_t WS_WIN = 4 * MiB, WS_WOA = 24 * MiB, WS_WOC = 26 * MiB, WS_WOUT = 28 * MiB;
constexpr size_t WS_H = 32 * MiB;
constexpr size_t WS_Q = 96 * MiB;
constexpr size_t WS_K = 160 * MiB, WS_V = 224 * MiB;
constexpr size_t WS_SG = 288 * MiB, WS_U = 352 * MiB, WS_G2 = 416 * MiB;
constexpr size_t WS_END = 480 * MiB;
constexpr int CW_BAR = 1024;

constexpr int RING_BYTES = 131072;
constexpr int LDS_BYTES = 147456;
constexpr int MISC_OFF = LDS_BYTES - 256;
static_assert(att::L_BYTES <= MISC_OFF && RING_BYTES <= MISC_OFF, "LDS map");

#define GAS __attribute__((address_space(1)))
#define LAS __attribute__((address_space(3)))
typedef unsigned short bf16;
typedef unsigned v4u __attribute__((ext_vector_type(4)));
typedef float f32x4 __attribute__((ext_vector_type(4)));
typedef GAS unsigned gu32;
#define RLX_AGENT __ATOMIC_RELAXED, __HIP_MEMORY_SCOPE_AGENT
#define LDS_WAIT() asm volatile("s_waitcnt lgkmcnt(0)" ::: "memory")
#define VM_WAIT() asm volatile("s_waitcnt vmcnt(0)" ::: "memory")
__device__ __forceinline__ unsigned f2bf(float f) { unsigned u = __builtin_bit_cast(unsigned, f); return (u + 0x7fffu + ((u >> 16) & 1u)) >> 16; }
__device__ __forceinline__ unsigned pk2(float lo, float hi) { return f2bf(lo) | (f2bf(hi) << 16); }

#define XB_TMO      128
#define XB_XCNT(j)  (256  + 64 * (j))
#define XB_XSUB(j)  (1280 + 64 * (j))
#define XB_XGEN(j)  (2304 + 64 * (j))
#define XB_TOP      3328
#define XB_TOPGEN   3392
#define XCD_BAR_WORDS 3456
#define XB_SPIN_CAP (1u << 18)

__device__ __forceinline__ unsigned xb_ld(unsigned* p)              { return __hip_atomic_load(p, __ATOMIC_RELAXED, __HIP_MEMORY_SCOPE_AGENT); }
__device__ __forceinline__ unsigned xb_add(unsigned* p, unsigned v) { return __hip_atomic_fetch_add(p, v, __ATOMIC_RELAXED, __HIP_MEMORY_SCOPE_AGENT); }
__device__ __forceinline__ unsigned xb_xcc_id() { return (unsigned)__builtin_amdgcn_s_getreg((3 << 11) | 20) & 0xFu; }
#define XB_SPIN(cond, bar) do { unsigned _sp = 0; while (cond) { __builtin_amdgcn_s_sleep(1); \
    if ((++_sp & 255u) == 0u) { if (xb_ld(&(bar)[XB_TMO])) break; if (_sp > XB_SPIN_CAP) { atomicAdd(&(bar)[XB_TMO], 1u); break; } } } } while (0)

struct XcdBarrier {
    unsigned* bar; unsigned x;
    volatile LAS unsigned* st;
};

__device__ __forceinline__ XcdBarrier xcd_barrier_post(unsigned* bar, volatile LAS unsigned* st) {
    XcdBarrier b; b.bar = bar; b.x = xb_xcc_id(); b.st = st;
    if (threadIdx.x == 0) (void)xb_add(&bar[XB_XCNT(b.x)], 1u);
    return b;
}
__device__ __forceinline__ void xcd_barrier_complete(unsigned* bar, unsigned x, unsigned& nloc, unsigned& nx) {
    const unsigned G = gridDim.x * gridDim.y * gridDim.z;
    unsigned sum, cnt, mine, sp = 0u;
    for (;;) {
        sum = 0u; cnt = 0u; mine = 0u;
#pragma unroll
        for (unsigned j = 0; j < 16; ++j) { const unsigned c = xb_ld(&bar[XB_XCNT(j)]); sum += c; cnt += (c > 0u) ? 1u : 0u; mine = (j == x) ? c : mine; }
        if (sum == G) break;
        __builtin_amdgcn_s_sleep(1);
        if ((++sp & 255u) == 0u) { if (xb_ld(&bar[XB_TMO])) break; if (sp > XB_SPIN_CAP) { atomicAdd(&bar[XB_TMO], 1u); break; } }
    }
    nloc = mine > 0u ? mine : 1u; nx = cnt > 0u ? cnt : 1u;
}

__device__ __forceinline__ void xcd_barrier(const XcdBarrier& b) {
    asm volatile("s_waitcnt vmcnt(0)" ::: "memory");
    __syncthreads();
    if (threadIdx.x == 0) {
        unsigned* bar = b.bar;
        __builtin_amdgcn_s_waitcnt(0);
        unsigned nloc = b.st[0], nx = b.st[1];
        if (nloc == 0u) { xcd_barrier_complete(bar, b.x, nloc, nx); b.st[0] = nloc; b.st[1] = nx; }
        const unsigned old = xb_add(&bar[XB_XSUB(b.x)], 1u);
        const unsigned gen = old / nloc;
        if (old + 1u == (gen + 1u) * nloc) {
            __builtin_amdgcn_fence(__ATOMIC_RELEASE, "agent");
            asm volatile("s_waitcnt vmcnt(0)" ::: "memory");
            const unsigned og = xb_add(&bar[XB_TOP], 1u);
            const unsigned tg = og / nx;
            if (og + 1u == (tg + 1u) * nx) xb_add(&bar[XB_TOPGEN], 1u);
            else XB_SPIN(xb_ld(&bar[XB_TOPGEN]) == tg, bar);
            __builtin_amdgcn_fence(__ATOMIC_ACQUIRE, "agent");
            xb_add(&bar[XB_XGEN(b.x)], 1u);
            asm volatile("s_waitcnt vmcnt(0)" ::: "memory");
        } else {
            XB_SPIN(xb_ld(&bar[XB_XGEN(b.x)]) == gen, bar);
            __builtin_amdgcn_fence(__ATOMIC_ACQUIRE, "agent");
            asm volatile("s_waitcnt vmcnt(0)" ::: "memory");
        }
    }
    __syncthreads();
}

struct Frame { LAS unsigned char* lds; int tid, lane, wave, vcu, G; };

__device__ __forceinline__ float wave_sum(float v) {
#pragma unroll
    for (int o = 1; o < 64; o <<= 1) v += __shfl_xor(v, o);
    return v;
}
__device__ __forceinline__ int win_dst_row(int n) {
    if (n < 4096 || n >= 8192) return n;
    const int g = n >> 10, c = (n & 1023) >> 7, o = n & 127;
    return ((g == 5 || g == 6) ? 4096 : 6144) + c * 256 + ((g == 6 || g == 7) ? 128 : 0) + o;
}
template <bool PERMW>
__device__ __forceinline__ void p0_transpose_item(const float* W, int K, int N, bf16* WT, LAS float* scr, int item, int lane) {
    const int nblk = N / 32, kb = item / nblk, nb = item % nblk, k0 = 64 * kb, n0 = 32 * nb;
    const int r0 = PERMW ? win_dst_row(n0) : n0;
#pragma unroll 8
    for (int i = 0; i < 32; ++i) { const int kk = 2 * i + (lane >> 5); scr[kk * 33 + (lane & 31)] = W[(size_t)(k0 + kk) * N + n0 + (lane & 31)]; }
    LDS_WAIT(); asm volatile("" ::: "memory");
    const int c = lane & 7;
#pragma unroll
    for (int j = 0; j < 4; ++j) { const int n = (lane >> 3) + 8 * j; const LAS float* s = scr + (8 * c) * 33 + n;
        v4u o; o.x = pk2(s[0 * 33], s[1 * 33]); o.y = pk2(s[2 * 33], s[3 * 33]); o.z = pk2(s[4 * 33], s[5 * 33]); o.w = pk2(s[6 * 33], s[7 * 33]);
        *(GAS v4u*)(WT + (size_t)(r0 + n) * K + k0 + 8 * c) = o; }
    LDS_WAIT(); asm volatile("" ::: "memory");
}

struct Args { const float* in[12]; float* out; unsigned char* ws; int ph_lo, ph_hi, li, pad; };

__device__ __forceinline__ att::URef make_ref(int k, int vcu, int G, unsigned char* ws) {
    const int p = vcu + (k >> 1) * G, bh = p >> 3, s = p & 7, own = (k & 1) ? s : 15 - s, b = bh >> 3, h = bh & 7;
    att::URef r;
    const size_t qo = ((size_t)(b * SEQ + own * 256)) * DM + h * HD;
    r.Q = (const att::bf16*)(ws + WS_Q) + qo; r.O = (att::bf16*)(ws + WS_Q) + qo; r.SG = (const att::bf16*)(ws + WS_SG) + qo;
    r.K = (const att::bf16*)(ws + WS_K) + (size_t)bh * SEQ * HD; r.V = (const att::bf16*)(ws + WS_V) + (size_t)bh * SEQ * HD;
    r.KP = (const float*)(ws + WS_KPART) + (size_t)bh * NBLK * 2 * HD; r.own = own; r.h = h;
    return r;
}

__global__ void __launch_bounds__(NWAVES * 64, 2) fwd_kernel(Args args) {
    extern __shared__ __attribute__((aligned(16))) unsigned char lds[];
    Frame F;
    F.lds = (LAS unsigned char*)lds;
    volatile LAS unsigned* MISC = (volatile LAS unsigned*)(F.lds + MISC_OFF);
    F.tid = threadIdx.x; F.lane = F.tid & 63; F.wave = __builtin_amdgcn_readfirstlane(F.tid >> 6);
    F.G = gridDim.x; { const int bx = blockIdx.x; F.vcu = (F.G % 8 == 0) ? (bx % 8) * (F.G / 8) + bx / 8 : bx; }
    unsigned char* ws = args.ws;
    gu32* ctl = (gu32*)(ws + WS_CTL);
    const float* x = args.in[0]; const float* cvec = args.in[1]; const float* norm_g = args.in[2]; const float* w_ada = args.in[3]; const float* b_ada = args.in[4];
    const float* w_in = args.in[5]; const float* conv_w = args.in[6]; const float* w_oa = args.in[7]; const float* w_oc = args.in[8]; const float* w_out = args.in[9];
    const float* rel_bias = args.in[10]; const float* final_g = args.in[11]; float* out = args.out;
    float* mod = (float*)(ws + WS_MOD);
    for (int u = F.tid; u < 64; u += NWAVES * 64) MISC[u] = 0u;
    __syncthreads();
    XcdBarrier bar; bar.bar = (unsigned*)(ctl + CW_BAR); bar.x = 0; bar.st = nullptr;
    if (N_LAUNCHES == 1) bar = xcd_barrier_post((unsigned*)(ctl + CW_BAR), MISC + 8);
#define GRID_BAR() do { if (N_LAUNCHES == 1) xcd_barrier(bar); } while (0)
    const int lo = args.ph_lo, hi = args.ph_hi;
#define IN(k) (lo <= (k) && (k) < hi)
#define BOTH(k) (IN(k) && IN((k) + 1))
    const int gw = F.vcu * NWAVES + F.wave, NGW = F.G * NWAVES;

    if (IN(0)) {
        LAS float* scr = (LAS float*)(F.lds + F.wave * 16384);
        constexpr int I_IN = (DM / 64) * (NIN / 32), I_SQ = (DM / 64) * (DM / 32);
        for (int it = gw; it < I_IN + 3 * I_SQ; it += NGW) {
            int r = it;
            if (r < I_IN) { p0_transpose_item<true>(w_in, DM, NIN, (bf16*)(ws + WS_WIN), scr, r, F.lane); continue; } r -= I_IN;
            if (r < I_SQ) { p0_transpose_item<false>(w_oa, DM, DM, (bf16*)(ws + WS_WOA), scr, r, F.lane); continue; } r -= I_SQ;
            if (r < I_SQ) { p0_transpose_item<false>(w_oc, DM, DM, (bf16*)(ws + WS_WOC), scr, r, F.lane); continue; } r -= I_SQ;
            p0_transpose_item<false>(w_out, DM, DM, (bf16*)(ws + WS_WOUT), scr, r, F.lane);
        }
        __syncthreads();
        if (F.vcu < 48) {
            LAS float* sc = (LAS float*)F.lds;
            LAS float* part = (LAS float*)(F.lds + 32768);
            for (int i = F.tid; i < BATCH * DM; i += NWAVES * 64) { const float v = cvec[i]; sc[i] = v / (1.0f + __expf(-v)); }
            __syncthreads();
            for (int it = F.vcu; it < 48; it += F.G) {
                const int n0 = it * 64; float a[BATCH];
#pragma unroll
                for (int b = 0; b < BATCH; ++b) a[b] = 0.f;
                const int kb = F.wave * 128;
#pragma unroll 4
                for (int kk = 0; kk < 128; ++kk) { const float wv = w_ada[(size_t)(kb + kk) * 3072 + n0 + F.lane];
#pragma unroll
                    for (int b = 0; b < BATCH; ++b) a[b] += sc[b * DM + kb + kk] * wv; }
#pragma unroll
                for (int b = 0; b < BATCH; ++b) part[(F.wave * BATCH + b) * 64 + F.lane] = a[b];
                __syncthreads();
                { const int b = F.tid >> 6, n = F.tid & 63; float s = b_ada[n0 + n];
#pragma unroll
                  for (int w = 0; w < NWAVES; ++w) s += part[(w * BATCH + b) * 64 + n];
                  mod[b * 3072 + n0 + n] = s; }
                __syncthreads();
            }
        }
        if (BOTH(0)) GRID_BAR();
    }

    if (IN(1)) {
        bf16* hb = (bf16*)(ws + WS_H);
        for (int ch = gw; ch < MTOK / 16; ch += NGW) {
            const int b = ch >> 8; f32x4 av[4], sv[4];
#pragma unroll
            for (int j = 0; j < 4; ++j) { const int col = 4 * F.lane + 256 * j;
                const f32x4 g = *(const f32x4*)(norm_g + col), sc = *(const f32x4*)(mod + b * 3072 + 1024 + col);
                av[j] = g * (sc + 1.0f); sv[j] = *(const f32x4*)(mod + b * 3072 + col); }
#pragma unroll 2
            for (int r = 0; r < 16; ++r) { const size_t row = (size_t)ch * 16 + r;
                const GAS f32x4* xr = (const GAS f32x4*)(x + row * DM) + F.lane;
                f32x4 v[4]; float s = 0.f;
#pragma unroll
                for (int j = 0; j < 4; ++j) { v[j] = xr[64 * j]; s += (v[j].x * v[j].x + v[j].y * v[j].y) + (v[j].z * v[j].z + v[j].w * v[j].w); }
                const float rs = 1.0f / sqrtf(wave_sum(s) * (1.0f / DM) + EPS);
                GAS unsigned long long* o8 = (GAS unsigned long long*)(hb + row * DM) + F.lane;
#pragma unroll
                for (int j = 0; j < 4; ++j) { const f32x4 y = v[j] * rs * av[j] + sv[j];
                    o8[64 * j] = (unsigned long long)pk2(y.x, y.y) | ((unsigned long long)pk2(y.z, y.w) << 32); } }
        }
        if (BOTH(1)) GRID_BAR();
    }

    if (IN(2)) {
        pg8::Gemm g{(const pg8::bf16_t*)(ws + WS_H), (const pg8::bf16_t*)(ws + WS_WIN), (const pg8::bf16_t*)(ws + WS_H), (const pg8::bf16_t*)(ws + WS_WIN), MTOK, NIN, DM};
        pg8::StaticOrder S; S.init(MTOK, NIN, F.G, (int)blockIdx.x);
        pg8::EpiIn E{(pg8::bf16_t*)(ws + WS_Q), (pg8::bf16_t*)(ws + WS_K), (pg8::bf16_t*)(ws + WS_V), (pg8::bf16_t*)(ws + WS_SG), (pg8::bf16_t*)(ws + WS_U), (pg8::bf16_t*)(ws + WS_G2),
                     (pg8::bf16_t*)out, (pg8::bf16_t*)out + (size_t)MTOK * DM, (float*)(ws + WS_KPART)};
        pg8::gemm_phase<pg8::EpiIn, pg8::StaticOrder, true, true>(F.lds, g, S, E);
        if (BOTH(2)) GRID_BAR();
    }

    if (IN(3)) {
        int nu = 0; for (int p = F.vcu; p < 512; p += F.G) nu += 2;
        if (nu > 0) {
            att::Seam S;
            att::URef cur = make_ref(0, F.vcu, F.G, ws);
            att::prime(cur, (char*)lds, S);
            for (int k = 0; k < nu; ++k) {
                const att::URef nxt = (k + 1 < nu) ? make_ref(k + 1, F.vcu, F.G, ws) : cur;
                att::block(cur, nxt, rel_bias, (char*)lds, S);
                cur = nxt;
            }
        }
        const bf16* ub = (const bf16*)(ws + WS_U); bf16* zb = (bf16*)(ws + WS_G2);
        for (int it = gw; it < 2048; it += NGW) {
            const int t0 = (it >> 1) * 32, ch = (it & 1) * 512 + F.lane * 8;
            float w0[8], w1[8], w2[8], um2[8], um1[8];
#pragma unroll
            for (int e = 0; e < 8; ++e) { w0[e] = conv_w[ch + e]; w1[e] = conv_w[DM + ch + e]; w2[e] = conv_w[2 * DM + ch + e]; um2[e] = 0.f; um1[e] = 0.f; }
            if ((t0 & (SEQ - 1)) != 0) {
                const v4u a = *(const v4u*)(ub + (size_t)(t0 - 2) * DM + ch), b = *(const v4u*)(ub + (size_t)(t0 - 1) * DM + ch);
                um2[0] = pg8::bf_lo(a.x); um2[1] = pg8::bf_hi(a.x); um2[2] = pg8::bf_lo(a.y); um2[3] = pg8::bf_hi(a.y); um2[4] = pg8::bf_lo(a.z); um2[5] = pg8::bf_hi(a.z); um2[6] = pg8::bf_lo(a.w); um2[7] = pg8::bf_hi(a.w);
                um1[0] = pg8::bf_lo(b.x); um1[1] = pg8::bf_hi(b.x); um1[2] = pg8::bf_lo(b.y); um1[3] = pg8::bf_hi(b.y); um1[4] = pg8::bf_lo(b.z); um1[5] = pg8::bf_hi(b.z); um1[6] = pg8::bf_lo(b.w); um1[7] = pg8::bf_hi(b.w);
            }
#pragma unroll 4
            for (int r = 0; r < 32; ++r) { const size_t off = (size_t)(t0 + r) * DM + ch;
                const v4u a = *(const v4u*)(ub + off), gq = *(const v4u*)(zb + off);
                float u0[8], gg[8], z[8];
                u0[0] = pg8::bf_lo(a.x); u0[1] = pg8::bf_hi(a.x); u0[2] = pg8::bf_lo(a.y); u0[3] = pg8::bf_hi(a.y); u0[4] = pg8::bf_lo(a.z); u0[5] = pg8::bf_hi(a.z); u0[6] = pg8::bf_lo(a.w); u0[7] = pg8::bf_hi(a.w);
                gg[0] = pg8::bf_lo(gq.x); gg[1] = pg8::bf_hi(gq.x); gg[2] = pg8::bf_lo(gq.y); gg[3] = pg8::bf_hi(gq.y); gg[4] = pg8::bf_lo(gq.z); gg[5] = pg8::bf_hi(gq.z); gg[6] = pg8::bf_lo(gq.w); gg[7] = pg8::bf_hi(gq.w);
#pragma unroll
                for (int e = 0; e < 8; ++e) { z[e] = gg[e] * (w0[e] * um2[e] + w1[e] * um1[e] + w2[e] * u0[e]); um2[e] = um1[e]; um1[e] = u0[e]; }
                v4u o; o.x = pk2(z[0], z[1]); o.y = pk2(z[2], z[3]); o.z = pk2(z[4], z[5]); o.w = pk2(z[6], z[7]);
                *(v4u*)(zb + off) = o; }
        }
        if (BOTH(3)) GRID_BAR();
    }

    if (IN(4)) {
        pg8::Gemm g{(const pg8::bf16_t*)(ws + WS_Q), (const pg8::bf16_t*)(ws + WS_WOA), (const pg8::bf16_t*)(ws + WS_G2), (const pg8::bf16_t*)(ws + WS_WOC), MTOK, DM, DM};
        pg8::PairOrder S; S.init(MTOK, DM, F.G, (int)blockIdx.x);
        pg8::EpiMerge E{(const pg8::bf16_t*)out, (const pg8::bf16_t*)out + (size_t)MTOK * DM, (float*)(ws + WS_K), (pg8::bf16_t*)(ws + WS_H)};
        pg8::gemm_phase<pg8::EpiMerge, pg8::PairOrder, true, true>(F.lds, g, S, E);
        if (BOTH(4)) GRID_BAR();
    }

    if (IN(5)) {
        pg8::Gemm g{(const pg8::bf16_t*)(ws + WS_H), (const pg8::bf16_t*)(ws + WS_WOUT), (const pg8::bf16_t*)(ws + WS_H), (const pg8::bf16_t*)(ws + WS_WOUT), MTOK, DM, DM};
        pg8::StaticOrder S; S.init(MTOK, DM, F.G, (int)blockIdx.x);
        pg8::EpiRes E{x, mod + 2048, out};
        pg8::gemm_phase<pg8::EpiRes, pg8::StaticOrder, true, true>(F.lds, g, S, E);
        if (BOTH(5)) GRID_BAR();
    }

    if (IN(6)) {
        f32x4 gv[4];
#pragma unroll
        for (int j = 0; j < 4; ++j) gv[j] = *(const f32x4*)(final_g + 4 * F.lane + 256 * j);
#pragma unroll 2
        for (int row = gw; row < MTOK; row += NGW) {
            GAS f32x4* xr = (GAS f32x4*)(out + (size_t)row * DM) + F.lane;
            f32x4 v[4]; float s = 0.f;
#pragma unroll
            for (int j = 0; j < 4; ++j) { v[j] = xr[64 * j]; s += (v[j].x * v[j].x + v[j].y * v[j].y) + (v[j].z * v[j].z + v[j].w * v[j].w); }
            const float rs = 1.0f / sqrtf(wave_sum(s) * (1.0f / DM) + EPS);
#pragma unroll
            for (int j = 0; j < 4; ++j) xr[64 * j] = v[j] * rs * gv[j];
        }
    }
#undef IN
#undef BOTH
#undef GRID_BAR
}

extern "C" void kernel_launch(void* const* d_in, const int* in_sizes, int n_in, void* d_out, int out_size, void* d_ws, size_t ws_size, hipStream_t stream) {
    static int grid = 0;
    if (grid == 0) {
        if (n_in != 12 || in_sizes[0] != MTOK * DM || out_size != MTOK * DM || ws_size < WS_END) {
            fprintf(stderr, "kernel_launch: unexpected shapes (n_in %d, in0 %d, out %d, ws %zu); nothing launched\n", n_in, n_in > 0 ? in_sizes[0] : -1, out_size, ws_size); grid = -1; return; }
        int dev = 0, cus = 0, per_cu = 0;
        if (hipGetDevice(&dev) != hipSuccess || hipDeviceGetAttribute(&cus, hipDeviceAttributeMultiprocessorCount, dev) != hipSuccess) { fprintf(stderr, "kernel_launch: device query failed\n"); grid = -1; return; }
        if (hipFuncSetAttribute((const void*)fwd_kernel, hipFuncAttributeMaxDynamicSharedMemorySize, LDS_BYTES) != hipSuccess) { fprintf(stderr, "kernel_launch: hipFuncSetAttribute failed\n"); grid = -1; return; }
        if (hipOccupancyMaxActiveBlocksPerMultiprocessor(&per_cu, (const void*)fwd_kernel, NWAVES * 64, LDS_BYTES) != hipSuccess || per_cu < 1)
            fprintf(stderr, "kernel_launch: note: occupancy query reports %d workgroups per CU\n", per_cu);
        (void)hipGetLastError();
        grid = cus;
    }
    if (grid < 0) return;
    if (hipMemsetAsync((char*)d_ws + WS_CTL, 0, CTL_ZERO_BYTES, stream) != hipSuccess) { fprintf(stderr, "kernel_launch: memset failed\n"); return; }
    Args a{};
    for (int i = 0; i < 12; ++i) a.in[i] = (const float*)d_in[i];
    a.out = (float*)d_out; a.ws = (unsigned char*)d_ws;
    for (int li = 0; li < N_LAUNCHES; ++li) {
        a.ph_lo = (N_LAUNCHES == 1) ? 0 : li; a.ph_hi = (N_LAUNCHES == 1) ? N_PHASES : li + 1; a.li = li;
        hipLaunchKernelGGL(fwd_kernel, dim3(grid), dim3(NWAVES * 64), LDS_BYTES, stream, a);
        const hipError_t le = hipPeekAtLastError();
        if (le != hipSuccess) { fprintf(stderr, "kernel_launch: launch %d failed: %s\n", li, hipGetErrorName(le)); break; }
    }
}
```
